# Optimizing an MI355X kernel written in HIP

```python
import math
import jax, jax.numpy as jnp
from jax import lax
import numpy as np

D_MODEL = 1024
BATCH = 8
SEQ = 4096
DEPTH = 4

N_MIXERS = 2
N_ATTN_LAYERS = (DEPTH + 1) // 2
N_SSM_LAYERS = DEPTH // 2

HEAD_DIM = 64
N_HEADS = D_MODEL // (2 * HEAD_DIM)
Q_BLOCK = 128

REL_BUCKETS = 32
REL_MAX_DIST = 128

GROUP_CH = 16
GROUPS = D_MODEL // GROUP_CH
SSM_STATE = 64
SSM_CHUNK = 128

D_FF = 2816
FFN_RESIDUAL = 0.5

PLE_DIM = 256

N_NORMS = 8
RMS_EPS = 1e-6
NEG_INF = -1e30

kernel_name = "hybrid_diffattn_s5_macaron_trunk"


def rmsnorm(x, g):
    xf = x.astype(jnp.float32)
    y = xf * lax.rsqrt(jnp.mean(xf * xf, axis=-1, keepdims=True) + RMS_EPS)
    return (y * g.astype(jnp.float32)).astype(x.dtype)


def swiglu(h, w_in, w_out):
    gu = h @ w_in
    return (jax.nn.silu(gu[..., :D_FF]) * gu[..., D_FF:]) @ w_out


def t5_bucket(n):
    n = jnp.maximum(n, 0)
    max_exact = REL_BUCKETS // 2
    nf = jnp.maximum(n, 1).astype(jnp.float32)
    large = max_exact + (jnp.log(nf / max_exact) / math.log(REL_MAX_DIST / max_exact)
                         * (REL_BUCKETS - max_exact)).astype(jnp.int32)
    large = jnp.minimum(large, REL_BUCKETS - 1)
    return jnp.where(n < max_exact, n, large)


def diff_attention(h, w_qkv, w_o, lam_vecs, subln_g, rel_bias, lambda_init):
    Bsz, S, _ = h.shape
    n_blk = S // Q_BLOCK
    qkv = h @ w_qkv
    q, k, v = jnp.split(qkv, 3, axis=-1)
    q = q.reshape(Bsz, S, N_HEADS, 2, HEAD_DIM).transpose(0, 2, 3, 1, 4) * (HEAD_DIM ** -0.5)
    k = k.reshape(Bsz, S, N_HEADS, 2, HEAD_DIM).transpose(0, 2, 3, 1, 4)
    v = v.reshape(Bsz, S, N_HEADS, 2 * HEAD_DIM).transpose(0, 2, 1, 3)

    lv = lam_vecs.astype(jnp.float32)
    lam = jnp.exp(jnp.sum(lv[0] * lv[1])) - jnp.exp(jnp.sum(lv[2] * lv[3])) + lambda_init

    q_blocks = jnp.moveaxis(q.reshape(Bsz, N_HEADS, 2, n_blk, Q_BLOCK, HEAD_DIM), 3, 0)
    k_pos = jnp.arange(S, dtype=jnp.int32)

    def block(args):
        q_blk, blk = args
        q_pos = blk * Q_BLOCK + jnp.arange(Q_BLOCK, dtype=jnp.int32)
        dist = q_pos[:, None] - k_pos[None, :]
        bias = rel_bias.astype(jnp.float32)[t5_bucket(dist)]
        bias = bias.reshape(Q_BLOCK, S, N_HEADS, 2).transpose(2, 3, 0, 1)
        s = jnp.einsum('bhmqd,bhmkd->bhmqk', q_blk, k).astype(jnp.float32) + bias
        s = jnp.where(dist >= 0, s, NEG_INF)
        prob = jax.nn.softmax(s, axis=-1)
        attn = prob[:, :, 0] - lam * prob[:, :, 1]
        return jnp.einsum('bhqk,bhkv->bhqv', attn.astype(v.dtype), v)

    o = lax.map(block, (q_blocks, jnp.arange(n_blk, dtype=jnp.int32)))
    o = jnp.moveaxis(o, 0, 2).reshape(Bsz, N_HEADS, S, 2 * HEAD_DIM)
    o = rmsnorm(o, subln_g) * (1.0 - lambda_init)
    o = o.transpose(0, 2, 1, 3).reshape(Bsz, S, D_MODEL)
    return o @ w_o


def s5_glu(h, lam_re, lam_im, log_dt, b_re, b_im, c_re, c_im, d_skip, w_glu, b_glu):
    Bsz, S, _ = h.shape
    n_chunks = S // SSM_CHUNK
    lam = lax.complex(lam_re.astype(jnp.float32), lam_im.astype(jnp.float32))
    dt = jnp.exp(log_dt.astype(jnp.float32))[:, None]
    lam_dt = lam * dt
    a_bar = jnp.exp(lam_dt)
    b = lax.complex(b_re.astype(jnp.float32), b_im.astype(jnp.float32))
    b_bar = ((a_bar - 1.0) / lam)[:, :, None] * b
    c = lax.complex(c_re.astype(jnp.float32), c_im.astype(jnp.float32))
    d_g = d_skip.astype(jnp.float32).reshape(GROUPS, GROUP_CH)
    steps = jnp.arange(1, SSM_CHUNK + 1, dtype=jnp.float32)
    a_pow = jnp.exp(steps[:, None, None] * lam_dt[None])

    u = h.astype(jnp.float32).reshape(Bsz, n_chunks, SSM_CHUNK, GROUPS, GROUP_CH)
    u = jnp.moveaxis(u, 1, 0)

    def combine(e1, e2):
        a1, x1 = e1
        a2, x2 = e2
        return a1 * a2, a2 * x1 + x2

    def chunk_step(state, u_c):
        bu = jnp.einsum('gph,bcgh->bcgp', b_bar, u_c.astype(jnp.complex64))
        a = jnp.broadcast_to(a_bar, bu.shape)
        _, xs = lax.associative_scan(combine, (a, bu), axis=1)
        xs = xs + a_pow[None] * state[:, None]
        y = jnp.einsum('ghp,bcgp->bcgh', c, xs).real + d_g * u_c
        return xs[:, -1], y

    state0 = jnp.zeros((Bsz, GROUPS, SSM_STATE), jnp.complex64)
    _, ys = lax.scan(chunk_step, state0, u)
    y = jnp.moveaxis(ys, 0, 1).reshape(Bsz, S, D_MODEL).astype(h.dtype)
    z = jax.nn.gelu(y) @ w_glu + b_glu
    return z[..., :D_MODEL] * jax.nn.sigmoid(z[..., D_MODEL:])


def setup_inputs(seed: int = 0) -> dict:
    key = jax.random.key(seed)
    ks = jax.random.split(key, 24)
    f32 = jnp.float32
    nrm = lambda k, shape, scale: jax.random.normal(k, shape, f32) * scale

    x = nrm(ks[0], (BATCH, SEQ, D_MODEL), 1.0)
    p = nrm(ks[1], (DEPTH, BATCH, SEQ, PLE_DIM), 1.0)
    norm_g = 1.0 + nrm(ks[2], (DEPTH, N_NORMS, D_MODEL), 0.05)
    ffn_w_in = nrm(ks[3], (DEPTH, 2, D_MODEL, 2 * D_FF), D_MODEL ** -0.5)
    ffn_w_out = nrm(ks[4], (DEPTH, 2, D_FF, D_MODEL), D_FF ** -0.5)

    attn_w_qkv = nrm(ks[5], (N_ATTN_LAYERS, D_MODEL, 3 * D_MODEL), D_MODEL ** -0.5)
    attn_w_o = nrm(ks[6], (N_ATTN_LAYERS, D_MODEL, D_MODEL), D_MODEL ** -0.5)
    attn_lam = nrm(ks[7], (N_ATTN_LAYERS, 4, HEAD_DIM), 0.1)
    attn_subln_g = 1.0 + nrm(ks[8], (N_ATTN_LAYERS, 2 * HEAD_DIM), 0.05)
    rel_bias = nrm(ks[9], (REL_BUCKETS, 2 * N_HEADS), 0.5)

    n_idx = jnp.arange(SSM_STATE, dtype=f32)
    ssm_lam_re = jnp.full((N_SSM_LAYERS, GROUPS, SSM_STATE), -0.5, f32) + nrm(ks[10], (N_SSM_LAYERS, GROUPS, SSM_STATE), 1e-3)
    ssm_lam_im = jnp.broadcast_to(math.pi * n_idx, (N_SSM_LAYERS, GROUPS, SSM_STATE)) + nrm(ks[11], (N_SSM_LAYERS, GROUPS, SSM_STATE), 1e-3)
    ssm_log_dt = jax.random.uniform(ks[12], (N_SSM_LAYERS, GROUPS), f32, math.log(1e-3), math.log(1e-1))
    b_scale = (2.0 * GROUP_CH) ** -0.5
    c_scale = (2.0 * SSM_STATE) ** -0.5
    ssm_b_re = nrm(ks[13], (N_SSM_LAYERS, GROUPS, SSM_STATE, GROUP_CH), b_scale)
    ssm_b_im = nrm(ks[14], (N_SSM_LAYERS, GROUPS, SSM_STATE, GROUP_CH), b_scale)
    ssm_c_re = nrm(ks[15], (N_SSM_LAYERS, GROUPS, GROUP_CH, SSM_STATE), c_scale)
    ssm_c_im = nrm(ks[16], (N_SSM_LAYERS, GROUPS, GROUP_CH, SSM_STATE), c_scale)
    ssm_d = nrm(ks[17], (N_SSM_LAYERS, D_MODEL), 1.0)
    ssm_w_glu = nrm(ks[18], (N_SSM_LAYERS, D_MODEL, 2 * D_MODEL), D_MODEL ** -0.5)
    ssm_b_glu = nrm(ks[19], (N_SSM_LAYERS, 2 * D_MODEL), 0.01)

    ple_w_proj = nrm(ks[20], (DEPTH, PLE_DIM, D_MODEL), PLE_DIM ** -0.5)
    ple_w_gate = nrm(ks[21], (DEPTH, D_MODEL, D_MODEL), D_MODEL ** -0.5)

    return {"x": x, "p": p, "norm_g": norm_g, "ffn_w_in": ffn_w_in, "ffn_w_out": ffn_w_out,
            "attn_w_qkv": attn_w_qkv, "attn_w_o": attn_w_o, "attn_lam": attn_lam,
            "attn_subln_g": attn_subln_g, "rel_bias": rel_bias,
            "ssm_lam_re": ssm_lam_re, "ssm_lam_im": ssm_lam_im, "ssm_log_dt": ssm_log_dt,
            "ssm_b_re": ssm_b_re, "ssm_b_im": ssm_b_im, "ssm_c_re": ssm_c_re, "ssm_c_im": ssm_c_im,
            "ssm_d": ssm_d, "ssm_w_glu": ssm_w_glu, "ssm_b_glu": ssm_b_glu,
            "ple_w_proj": ple_w_proj, "ple_w_gate": ple_w_gate}


def reference(x, p, norm_g, ffn_w_in, ffn_w_out, attn_w_qkv, attn_w_o, attn_lam, attn_subln_g,
              rel_bias, ssm_lam_re, ssm_lam_im, ssm_log_dt, ssm_b_re, ssm_b_im, ssm_c_re, ssm_c_im,
              ssm_d, ssm_w_glu, ssm_b_glu, ple_w_proj, ple_w_gate):
    for i in range(DEPTH):
        g = norm_g[i]
        x = x + FFN_RESIDUAL * rmsnorm(swiglu(rmsnorm(x, g[0]), ffn_w_in[i, 0], ffn_w_out[i, 0]), g[1])
        h = rmsnorm(x, g[2])
        j = i // N_MIXERS
        if i % N_MIXERS == 0:
            lambda_init = 0.8 - 0.6 * math.exp(-0.3 * i)
            m = diff_attention(h, attn_w_qkv[j], attn_w_o[j], attn_lam[j], attn_subln_g[j],
                               rel_bias, lambda_init)
        else:
            m = s5_glu(h, ssm_lam_re[j], ssm_lam_im[j], ssm_log_dt[j], ssm_b_re[j], ssm_b_im[j],
                       ssm_c_re[j], ssm_c_im[j], ssm_d[j], ssm_w_glu[j], ssm_b_glu[j])
        x = x + rmsnorm(m, g[3])
        x = x + FFN_RESIDUAL * rmsnorm(swiglu(rmsnorm(x, g[4]), ffn_w_in[i, 1], ffn_w_out[i, 1]), g[5])
        gate = jax.nn.sigmoid(rmsnorm(x, g[6]) @ ple_w_gate[i])
        x = x + rmsnorm(gate * (p[i] @ ple_w_proj[i]), g[7])
    return x
```

```cpp
#include <hip/hip_runtime.h>
#include <hip/hip_cooperative_groups.h>
#include <cstdio>
#include <cstdint>
namespace cg = cooperative_groups;
namespace pg8 {
#define PG8_LAS __attribute__((address_space(3)))
typedef unsigned short bf16_t;
typedef short bf16x8 __attribute__((ext_vector_type(8)));
typedef float f32x4 __attribute__((ext_vector_type(4)));
typedef unsigned u32x4 __attribute__((ext_vector_type(4)));
constexpr int BM = 256, BK = 64, HALF = 128, HTB = HALF * BK * 2  , STAGE_BYTES = 8 * HTB, NXCD = 8, WGM = 8;

__host__ __device__ __forceinline__ int lds_byte(int r, int c) { const int st = (r >> 4) * 2 + (c >> 5), rr = r & 15, cc = c & 31, ob = rr * 64 + cc * 2; return st * 1024 + (ob ^ (((ob >> 9) & 1) << 5)); }
__host__ __device__ __forceinline__ void stage_rc(int b, int& R, int& C) { const int st = b / 1024, sb = b % 1024, swz = sb ^ (((sb >> 9) & 1) << 5); R = (st >> 1) * 16 + swz / 64; C = (st & 1) * 32 + (swz % 64) / 2; }
__host__ __device__ __forceinline__ int perm32(int rho) { const int n = rho >> 4, i = rho & 15; return 8 * (i >> 2) + 4 * n + (i & 3); }

struct Unit { int pm, pn; };
struct Gemm { const bf16_t* A; const bf16_t* Bt; int M, N, K; };
struct StaticOrder {
    int nM, nN, nwg, G, c;
    __host__ __device__ void init(int M, int N, int G_, int c_) { nM = M / BM; nN = N / BM; nwg = nM * nN; G = G_; c = c_; }
    __host__ __device__ bool next(int i, Unit& u) const {
        const long L = (long)i * G + c; if (L >= nwg) return false;
        int wgid = (int)L; { const int q = nwg / NXCD, r = nwg % NXCD, xcd = wgid % NXCD, off = wgid / NXCD; wgid = (xcd < r ? xcd * (q + 1) : r * (q + 1) + (xcd - r) * q) + off; }
        const int nig = WGM * nN, gid = wgid / nig, fm = gid * WGM, gsz = (nM - fm) < WGM ? (nM - fm) : WGM;
        u.pm = fm + ((wgid % nig) % gsz); u.pn = (wgid % nig) / gsz; return true;
    }
    __device__ __forceinline__ void a_ready(const Unit&) const {}
    __device__ __forceinline__ void done(const Unit&) const {}
};

__device__ __forceinline__ unsigned cvt_pk_bf16(float lo, float hi) { unsigned r; asm volatile("v_cvt_pk_bf16_f32 %0, %1, %2" : "=v"(r) : "v"(lo), "v"(hi)); return r; }
typedef float f32x2 __attribute__((ext_vector_type(2)));
__device__ __forceinline__ float fast_sigmoid(float v) { return __builtin_amdgcn_rcpf(1.0f + __builtin_amdgcn_exp2f(-1.4426950408889634f * v)); }
struct EpiBf16S {
    static constexpr bool PERM = true, AFTER_DRAIN = false;
    bf16_t* O; int ldc; int split_cols; size_t split_stride; float scale0;
    __device__ __forceinline__ void operator()(const f32x4 (&acc)[2][2][4][2], const Unit& u, int wr, int wc, int fr, int fq) const {
        const int row0 = u.pm * BM + wr * 64 + fr; int colt = u.pn * BM; bf16_t* base = O;
        float sc = 1.f; if (split_cols) { const int t = colt / split_cols; base += (size_t)t * split_stride; colt -= t * split_cols; if (t == 0) sc = scale0; }
        const int col0 = colt + wc * 32 + 8 * fq;
#pragma unroll
        for (int ai = 0; ai < 2; ++ai)
#pragma unroll
            for (int m = 0; m < 4; ++m) { bf16_t* rowp = base + (size_t)(row0 + ai * HALF + m * 16) * ldc + col0;
#pragma unroll
                for (int bj = 0; bj < 2; ++bj) { f32x4 v0 = acc[ai][bj][m][0] * sc, v1 = acc[ai][bj][m][1] * sc;
                    u32x4 w; w.x = cvt_pk_bf16(v0[0], v0[1]); w.y = cvt_pk_bf16(v0[2], v0[3]); w.z = cvt_pk_bf16(v1[0], v1[1]); w.w = cvt_pk_bf16(v1[2], v1[3]);
                    *(u32x4*)(rowp + bj * HALF) = w; } }
    }
};
struct EpiSwiGLU {
    static constexpr bool PERM = true, AFTER_DRAIN = false;
    bf16_t* O; int ldc;
    __device__ __forceinline__ void operator()(const f32x4 (&acc)[2][2][4][2], const Unit& u, int wr, int wc, int fr, int fq) const {
        const int row0 = u.pm * BM + wr * 64 + fr; const int col0 = u.pn * HALF + wc * 32 + 8 * fq;
#pragma unroll
        for (int ai = 0; ai < 2; ++ai)
#pragma unroll
            for (int m = 0; m < 4; ++m) { bf16_t* rowp = O + (size_t)(row0 + ai * HALF + m * 16) * ldc + col0;
                float o[8];
#pragma unroll
                for (int n = 0; n < 2; ++n)
#pragma unroll
                    for (int j = 0; j < 4; ++j) { const float g = acc[ai][0][m][n][j], up = acc[ai][1][m][n][j]; o[n * 4 + j] = g * fast_sigmoid(g) * up; }
                u32x4 w; w.x = cvt_pk_bf16(o[0], o[1]); w.y = cvt_pk_bf16(o[2], o[3]); w.z = cvt_pk_bf16(o[4], o[5]); w.w = cvt_pk_bf16(o[6], o[7]);
                *(u32x4*)rowp = w; }
    }
};
struct EpiGLU {
    static constexpr bool PERM = true, AFTER_DRAIN = false;
    float* O; int ldc; const float* bias; int half;
    __device__ __forceinline__ void operator()(const f32x4 (&acc)[2][2][4][2], const Unit& u, int wr, int wc, int fr, int fq) const {
        const int row0 = u.pm * BM + wr * 64 + fr; const int col0 = u.pn * HALF + wc * 32 + 8 * fq;
        f32x4 bv[2], bg[2];
#pragma unroll
        for (int n = 0; n < 2; ++n) { bv[n] = *(const f32x4*)(bias + col0 + 4 * n); bg[n] = *(const f32x4*)(bias + half + col0 + 4 * n); }
#pragma unroll
        for (int ai = 0; ai < 2; ++ai)
#pragma unroll
            for (int m = 0; m < 4; ++m) { float* rowp = O + (size_t)(row0 + ai * HALF + m * 16) * ldc + col0;
#pragma unroll
                for (int n = 0; n < 2; ++n) { const f32x4 v = acc[ai][0][m][n] + bv[n], g = acc[ai][1][m][n] + bg[n]; f32x4 o;
#pragma unroll
                    for (int j = 0; j < 4; ++j) o[j] = v[j] * fast_sigmoid(g[j]);
                    *(f32x4*)(rowp + 4 * n) = o; } }
    }
};
template <int MODE> struct EpiF32 {
    static constexpr bool PERM = false, AFTER_DRAIN = false;
    float* O; int ldc;
    __device__ __forceinline__ void operator()(const f32x4 (&acc)[2][2][4][2], const Unit& u, int wr, int wc, int fr, int fq) const {
        const int row0 = u.pm * BM + wr * 64 + fr; const int col0 = u.pn * BM + wc * 32 + 4 * fq;
#pragma unroll
        for (int ai = 0; ai < 2; ++ai)
#pragma unroll
            for (int m = 0; m < 4; ++m) { float* rowp = O + (size_t)(row0 + ai * HALF + m * 16) * ldc + col0;
#pragma unroll
                for (int bj = 0; bj < 2; ++bj)
#pragma unroll
                    for (int n = 0; n < 2; ++n) { f32x4 v = acc[ai][bj][m][n]; float* p = rowp + bj * HALF + n * 16;
                        if (MODE == 1) { const f32x4 pp = *(const f32x4*)p;
#pragma unroll
                            for (int j = 0; j < 4; ++j) v[j] = fast_sigmoid(v[j]) * pp[j]; }
                        *(f32x4*)p = v; } }
    }
};
template <class Epi, class Sched, bool ALIGN_EPI = false, bool SP2 = false>
__device__ __forceinline__ void gemm_phase(PG8_LAS unsigned char* lds, const Gemm g, const Sched& S, const Epi& E) {
    int tid_ = threadIdx.x; asm volatile("" : "+v"(tid_));
    const int tid = tid_, wid = __builtin_amdgcn_readfirstlane(tid >> 6), lane = tid & 63, wr = wid >> 2, wc = wid & 3, fr = lane & 15, fq = lane >> 4;
    const int K = g.K, nt = K / BK;
    unsigned voffA[2], voffB[2];
#pragma unroll
    for (int i = 0; i < 2; ++i) { int R, C; stage_rc(tid * 16 + i * 8192, R, C); const int Rb = Epi::PERM ? ((R & ~31) + perm32(R & 31)) : R;
        voffA[i] = (unsigned)(R * K + C) * 2u; voffB[i] = (unsigned)(Rb * K + C) * 2u; }
    const size_t kstep = (size_t)(BK * 2);
    const size_t hstep = (size_t)HALF * K * 2;
    const size_t tstep = 2 * hstep;
    const unsigned ldsw = (unsigned)wid * 1024u;
    const int aoff = lds_byte(wr * 64 + fr, fq * 8), boff = lds_byte(wc * 32 + fr, fq * 8);
#define PG8_SA(b, h) (((b) * 2 + (h)) * HTB)
#define PG8_SB(b, h) ((4 + (b) * 2 + (h)) * HTB)
#define PG8_STAGE(bufoff, gbase, voff) do { _Pragma("unroll") for (int _i = 0; _i < 2; ++_i) \
        __builtin_amdgcn_global_load_lds((const unsigned*)((const char*)(gbase) + (voff)[_i]), (PG8_LAS unsigned*)(lds + (bufoff) + ldsw + _i * 8192), 16, 0, 0); } while (0)
#define PG8_LDA(dst, b, h) do { _Pragma("unroll") for (int m = 0; m < 4; ++m) _Pragma("unroll") for (int k = 0; k < 2; ++k) dst[m][k] = *(const PG8_LAS bf16x8*)(lds + PG8_SA(b, h) + aoff + m * 2048 + k * 1024); } while (0)
#define PG8_LDB(dst, b, h) do { _Pragma("unroll") for (int n = 0; n < 2; ++n) _Pragma("unroll") for (int k = 0; k < 2; ++k) dst[n][k] = *(const PG8_LAS bf16x8*)(lds + PG8_SB(b, h) + boff + n * 2048 + k * 1024); } while (0)
#define PG8_MMA(ai, bj, At, Bt) do { __builtin_amdgcn_s_setprio(1); _Pragma("unroll") for (int m = 0; m < 4; ++m) _Pragma("unroll") for (int n = 0; n < 2; ++n) _Pragma("unroll") for (int k = 0; k < 2; ++k) \
        acc[ai][bj][m][n] = __builtin_amdgcn_mfma_f32_16x16x32_bf16(Bt[n][k], At[m][k], acc[ai][bj][m][n], 0, 0, 0); __builtin_amdgcn_s_setprio(0); } while (0)
#define PG8_WAIT_V(n) asm volatile("s_waitcnt vmcnt(" #n ")" ::: "memory")
#define PG8_WAIT_L(n) asm volatile("s_waitcnt lgkmcnt(" #n ")" ::: "memory")
#define PG8_BAR __builtin_amdgcn_s_barrier()
#define PG8_SCHED __builtin_amdgcn_sched_barrier(0)
    Unit cur, nxt; int ui = 0;
    if (!S.next(0, cur)) return;
    f32x4 acc[2][2][4][2];
#pragma unroll
    for (int a = 0; a < 2; ++a)
#pragma unroll
        for (int b = 0; b < 2; ++b)
#pragma unroll
            for (int m = 0; m < 4; ++m)
#pragma unroll
                for (int n = 0; n < 2; ++n) acc[a][b][m][n] = (f32x4){0.f, 0.f, 0.f, 0.f};
    bf16x8 At[4][2], B0[2][2], B1[2][2];
    const char* cA = (const char*)g.A + (size_t)cur.pm * tstep; const char* cB = (const char*)g.Bt + (size_t)cur.pn * tstep;
    S.a_ready(cur);
    if constexpr (SP2) {
        PG8_STAGE(PG8_SB(0, 0), cB, voffB); PG8_STAGE(PG8_SB(0, 1), cB + hstep, voffB); PG8_STAGE(PG8_SA(0, 0), cA, voffA); PG8_STAGE(PG8_SA(0, 1), cA + hstep, voffA);
        if (wr == 1) PG8_BAR;
        PG8_WAIT_V(2); PG8_BAR;
        PG8_STAGE(PG8_SB(1, 0), cB + kstep, voffB); PG8_STAGE(PG8_SA(1, 0), cA + kstep, voffA); PG8_STAGE(PG8_SB(1, 1), cB + hstep + kstep, voffB);
        PG8_WAIT_V(6); PG8_BAR;
    } else {
        PG8_STAGE(PG8_SB(0, 0), cB, voffB); PG8_STAGE(PG8_SA(0, 0), cA, voffA); PG8_STAGE(PG8_SB(0, 1), cB + hstep, voffB); PG8_STAGE(PG8_SA(0, 1), cA + hstep, voffA);
        if (wr == 1) PG8_BAR;
        PG8_WAIT_V(4); PG8_BAR;
        PG8_STAGE(PG8_SB(1, 0), cB + kstep, voffB); PG8_STAGE(PG8_SA(1, 0), cA + kstep, voffA); PG8_STAGE(PG8_SB(1, 1), cB + hstep + kstep, voffB);
        PG8_WAIT_V(6); PG8_BAR;
    }
    for (;;) {
        const bool has_next = S.next(ui + 1, nxt);
        const char* nA = has_next ? (const char*)g.A + (size_t)nxt.pm * tstep : cA; const char* nB = has_next ? (const char*)g.Bt + (size_t)nxt.pn * tstep : cB;
        for (int t = 0; t < nt; t += 2) {
            const bool last = (t == nt - 2);
            const char* a1 = cA + (size_t)(t + 1) * kstep;
            const char* a2 = last ? nA : cA + (size_t)(t + 2) * kstep; const char* b2 = last ? nB : cB + (size_t)(t + 2) * kstep;
            const char* a3 = a2 + kstep; const char* b3 = b2 + kstep;
            if (last && has_next) S.a_ready(nxt);
            if constexpr (SP2) {
            PG8_LDB(B0, 0, 0); PG8_LDB(B1, 0, 1); PG8_SCHED; PG8_LDA(At, 0, 0); PG8_STAGE(PG8_SA(1, 1), a1 + hstep, voffA);
            PG8_WAIT_V(8); PG8_WAIT_L(0); PG8_BAR; PG8_MMA(0, 0, At, B0); PG8_MMA(0, 1, At, B1); PG8_BAR; PG8_SCHED;
            PG8_LDA(At, 0, 1); PG8_STAGE(PG8_SB(0, 0), b2, voffB); PG8_STAGE(PG8_SB(0, 1), b2 + hstep, voffB); PG8_STAGE(PG8_SA(0, 0), a2, voffA);
            PG8_WAIT_V(8); PG8_WAIT_L(0); PG8_BAR; PG8_MMA(1, 0, At, B0); PG8_MMA(1, 1, At, B1); PG8_BAR; PG8_SCHED;
            PG8_LDB(B0, 1, 0); PG8_LDB(B1, 1, 1); PG8_SCHED; PG8_LDA(At, 1, 0); PG8_STAGE(PG8_SA(0, 1), a2 + hstep, voffA);
            PG8_WAIT_V(8); PG8_WAIT_L(0); PG8_BAR; PG8_MMA(0, 0, At, B0); PG8_MMA(0, 1, At, B1); PG8_BAR; PG8_SCHED;
            PG8_LDA(At, 1, 1); PG8_STAGE(PG8_SB(1, 0), b3, voffB); PG8_STAGE(PG8_SB(1, 1), b3 + hstep, voffB); PG8_STAGE(PG8_SA(1, 0), a3, voffA);
            PG8_WAIT_V(8); PG8_WAIT_L(0); PG8_BAR; PG8_MMA(1, 0, At, B0); PG8_MMA(1, 1, At, B1); PG8_BAR; PG8_SCHED;
            } else {
            PG8_LDB(B0, 0, 0); PG8_SCHED; PG8_LDA(At, 0, 0); PG8_STAGE(PG8_SA(1, 1), a1 + hstep, voffA);
            PG8_WAIT_L(8); PG8_BAR; PG8_WAIT_L(0); PG8_MMA(0, 0, At, B0); PG8_BAR; PG8_SCHED;
            PG8_LDB(B1, 0, 1); PG8_STAGE(PG8_SB(0, 0), b2, voffB);
            PG8_BAR; PG8_WAIT_L(0); PG8_MMA(0, 1, At, B1); PG8_BAR;
            PG8_LDA(At, 0, 1); PG8_STAGE(PG8_SA(0, 0), a2, voffA);
            PG8_BAR; PG8_WAIT_L(0); PG8_MMA(1, 0, At, B0); PG8_BAR; PG8_SCHED;
            PG8_STAGE(PG8_SB(0, 1), b2 + hstep, voffB);
            PG8_WAIT_V(6); PG8_BAR; PG8_MMA(1, 1, At, B1); PG8_BAR;
            PG8_LDB(B0, 1, 0); PG8_SCHED; PG8_LDA(At, 1, 0); PG8_STAGE(PG8_SA(0, 1), a2 + hstep, voffA);
            PG8_WAIT_L(8); PG8_BAR; PG8_WAIT_L(0); PG8_MMA(0, 0, At, B0); PG8_BAR; PG8_SCHED;
            PG8_LDB(B1, 1, 1); PG8_STAGE(PG8_SB(1, 0), b3, voffB);
            PG8_BAR; PG8_WAIT_L(0); PG8_MMA(0, 1, At, B1); PG8_BAR;
            PG8_LDA(At, 1, 1); PG8_STAGE(PG8_SA(1, 0), a3, voffA);
            PG8_BAR; PG8_WAIT_L(0); PG8_MMA(1, 0, At, B0); PG8_BAR; PG8_SCHED;
            PG8_STAGE(PG8_SB(1, 1), b3 + hstep, voffB);
            PG8_WAIT_V(6); PG8_BAR; PG8_MMA(1, 1, At, B1); PG8_BAR;
            }
        }
        if constexpr (ALIGN_EPI) { if (wr == 0) PG8_BAR; }
        if constexpr (!Epi::AFTER_DRAIN) { E(acc, cur, wr, wc, fr, fq); S.done(cur); }
        if (!has_next) break;
#pragma unroll
        for (int a = 0; a < 2; ++a)
#pragma unroll
            for (int b = 0; b < 2; ++b)
#pragma unroll
                for (int m = 0; m < 4; ++m)
#pragma unroll
                    for (int n = 0; n < 2; ++n) acc[a][b][m][n] = (f32x4){0.f, 0.f, 0.f, 0.f};
        cur = nxt; cA = nA; cB = nB; ++ui;
        if constexpr (ALIGN_EPI) { if (wr == 1) PG8_BAR; }
    }
    PG8_WAIT_V(0);
    if constexpr (!ALIGN_EPI) { if (wr == 0) PG8_BAR; }
    PG8_BAR;
    if constexpr (Epi::AFTER_DRAIN) { E.fused(acc, cur, wr, wc, fr, fq, lds, wid, lane); S.done(cur); }
#undef PG8_SA
#undef PG8_SB
#undef PG8_STAGE
#undef PG8_LDA
#undef PG8_LDB
#undef PG8_MMA
#undef PG8_WAIT_V
#undef PG8_WAIT_L
#undef PG8_BAR
#undef PG8_SCHED
}
}
#define LAS __attribute__((address_space(3)))
typedef unsigned short bf16;
typedef short bf16x8 __attribute__((ext_vector_type(8)));
typedef short s16x4 __attribute__((ext_vector_type(4)));
typedef float f32x4 __attribute__((ext_vector_type(4)));
typedef float f32x16 __attribute__((ext_vector_type(16)));
typedef unsigned v4u __attribute__((ext_vector_type(4)));
typedef unsigned v2u __attribute__((ext_vector_type(2)));

constexpr int DM = 1024, SEQ = 4096, M = 32768, DFF = 2816, PLE = 256;
constexpr float RMS_EPS = 1e-6f, LOG2E = 1.4426950408889634f;
constexpr size_t MiB = 1u << 20;
constexpr size_t WS_WIN = 2 * MiB, WS_WOUT = 90 * MiB, WS_WQKV = 134 * MiB, WS_WO = 146 * MiB, WS_WGLU = 150 * MiB, WS_WGATE = 158 * MiB, WS_WPROJ = 166 * MiB;
constexpr size_t WS_XN = 168 * MiB, WS_HQ = 232 * MiB, WS_Y = 424 * MiB, WS_PB = 552 * MiB, WS_END = 616 * MiB;
constexpr int LDS_BYTES = 147456;

struct Params { const float* in[22]; float* out; unsigned char* ws; };

__device__ __forceinline__ float wave_sum(float v) {
#pragma unroll
    for (int o = 1; o < 64; o <<= 1) v += __shfl_xor(v, o);
    return v;
}
__device__ __forceinline__ unsigned pk2(float lo, float hi) { return pg8::cvt_pk_bf16(lo, hi); }
#define LDS_WAIT() asm volatile("s_waitcnt lgkmcnt(0)" ::: "memory")

__device__ __forceinline__ void transpose_item(const float* __restrict__ W, int K, int N, bf16* WT, const float* gain, int gmod, float gscale, int half, LAS float* scr, int item, int lane) {
    const int nblk = N / 32, kb = item / nblk, nb = item % nblk, k0 = 64 * kb, n0 = 32 * nb;
#pragma unroll 8
    for (int i = 0; i < 32; ++i) { const int kk = 2 * i + (lane >> 5); float w = W[(size_t)(k0 + kk) * N + n0 + (lane & 31)];
        if (gain) w *= gain[(k0 + kk) & (gmod - 1)] * gscale; scr[kk * 33 + (lane & 31)] = w; }
    LDS_WAIT();
    int r0 = n0;
    if (half) { const int nn = n0 >= half ? n0 - half : n0; r0 = 256 * (nn / 128) + (nn % 128) + (n0 >= half ? 128 : 0); }
    const int c = lane & 7;
#pragma unroll
    for (int j = 0; j < 4; ++j) { const int n = (lane >> 3) + 8 * j; const LAS float* s = scr + (8 * c) * 33 + n;
        v4u o; o.x = pk2(s[0 * 33], s[1 * 33]); o.y = pk2(s[2 * 33], s[3 * 33]); o.z = pk2(s[4 * 33], s[5 * 33]); o.w = pk2(s[6 * 33], s[7 * 33]);
        *(v4u*)(WT + (size_t)(r0 + n) * K + k0 + 8 * c) = o; }
    LDS_WAIT();
}

__device__ __forceinline__ void rowpass(const float* xin, const float* y, const float* g, float alpha, float* xout, bf16* xn, int gw, int NGW, int lane) {
    for (int m = gw; m < M; m += NGW) {
        const f32x4* xr = (const f32x4*)(xin + (size_t)m * DM) + lane;
        f32x4 v[4];
#pragma unroll
        for (int j = 0; j < 4; ++j) v[j] = xr[64 * j];
        if (y) {
            const f32x4* yr = (const f32x4*)(y + (size_t)m * DM) + lane; f32x4 yv[4]; float ss = 0.f;
#pragma unroll
            for (int j = 0; j < 4; ++j) { yv[j] = yr[64 * j]; ss += (yv[j].x * yv[j].x + yv[j].y * yv[j].y) + (yv[j].z * yv[j].z + yv[j].w * yv[j].w); }
            ss = wave_sum(ss); const float r = rsqrtf(ss * (1.f / DM) + RMS_EPS) * alpha;
#pragma unroll
            for (int j = 0; j < 4; ++j) { const f32x4 gv = ((const f32x4*)g)[lane + 64 * j]; v[j] += yv[j] * gv * r; }
        }
        float s2 = 0.f;
#pragma unroll
        for (int j = 0; j < 4; ++j) s2 += (v[j].x * v[j].x + v[j].y * v[j].y) + (v[j].z * v[j].z + v[j].w * v[j].w);
        s2 = wave_sum(s2); const float rstd = rsqrtf(s2 * (1.f / DM) + RMS_EPS);
        f32x4* xo = (f32x4*)(xout + (size_t)m * DM) + lane; v2u* o8 = (v2u*)(xn + (size_t)m * DM) + lane;
#pragma unroll
        for (int j = 0; j < 4; ++j) { xo[64 * j] = v[j]; v2u w; w.x = pk2(v[j].x * rstd, v[j].y * rstd); w.y = pk2(v[j].z * rstd, v[j].w * rstd); o8[64 * j] = w; }
    }
}

__device__ __forceinline__ int crow(int r, int hi) { return (r & 3) + 8 * (r >> 2) + 4 * hi; }
__device__ __forceinline__ float swap_max(float m) { auto rr = __builtin_amdgcn_permlane32_swap(__float_as_uint(m), __float_as_uint(m), false, false); return fmaxf(__uint_as_float(rr[0]), __uint_as_float(rr[1])); }
__device__ __forceinline__ float swap_sum(float m) { auto rr = __builtin_amdgcn_permlane32_swap(__float_as_uint(m), __float_as_uint(m), false, false); return __uint_as_float(rr[0]) + __uint_as_float(rr[1]); }
__device__ __forceinline__ s16x4 vtr(const LAS unsigned char* p) { typedef short v4i16_t __attribute__((ext_vector_type(4))); return __builtin_bit_cast(s16x4, __builtin_amdgcn_ds_read_tr16_b64_v4i16((LAS v4i16_t*)p)); }
__device__ __forceinline__ int t5_bucket(int n) { if (n < 16) return n; const float v = __logf((float)n * (1.f / 16.f)) * (16.f / 2.0794415416798357f); const int b = 16 + (int)v; return b < 31 ? b : 31; }

constexpr int KSTR = 272, VSTR = 320;
constexpr int A_K = 0, A_V = 2 * 64 * KSTR, A_TAB = A_V + 2 * 64 * VSTR, A_SCR = A_TAB + 2 * 384 * 4, A_OEX = A_SCR + 8 * 128, A_END = A_OEX + 65536;
static_assert(A_END <= LDS_BYTES, "attention LDS");

__device__ __forceinline__ void attention_phase(LAS unsigned char* lds, const bf16* __restrict__ Qp, const bf16* __restrict__ Kp, const bf16* __restrict__ Vp, bf16* __restrict__ Op,
                                                const float* __restrict__ lv, const float* __restrict__ rel_bias, float lambda_init, int vcu, int G) {
    int tid_ = threadIdx.x; asm volatile("" : "+v"(tid_));
    const int tid = tid_, lane = tid & 63, wid = __builtin_amdgcn_readfirstlane(tid >> 6), n = lane & 31, hi = lane >> 5, map = wid >> 2, qg = wid & 3;
    float lam;
    { float a_ = lv[lane] * lv[64 + lane], b_ = lv[128 + lane] * lv[192 + lane]; a_ = wave_sum(a_); b_ = wave_sum(b_); lam = __expf(a_) - __expf(b_) + lambda_init; }
    LAS float* tab = (LAS float*)(lds + A_TAB);
    LAS float* scr = (LAS float*)(lds + A_SCR) + wid * 32;
    LAS float* oex = (LAS float*)(lds + A_OEX) + qg * 4096;
    const int vbase = (4 * (lane >> 5) + ((lane & 15) >> 2)) * VSTR + (16 * ((lane >> 4) & 1) + 4 * (lane & 3)) * 2;
    for (int u = vcu; u < 2048; u += G) {
        const int v_ = u & 255, k_ = u >> 8, bh = v_ >> 2, j_ = v_ & 3, pair = k_ >> 1, qb = (k_ & 1) ? (8 * pair + 7 - j_) : (8 * pair + j_);
        const int b = bh >> 3, h = bh & 7;
        const size_t rowb = (size_t)b * SEQ;
        const int q0w = 128 * qb + 32 * qg, NT = 2 * qb + 2;
        bf16x8 qf[4];
        { const bf16* qp = Qp + (rowb + q0w + n) * DM + h * 128 + map * 64 + 8 * hi;
#pragma unroll
          for (int ds = 0; ds < 4; ++ds) qf[ds] = *(const bf16x8*)(qp + 16 * ds); }
        for (int e = tid; e < 768; e += 512) { const int mp = e >= 384 ? 1 : 0, dist = e - 384 * mp - 128;
            tab[e] = dist < 0 ? -1e30f : rel_bias[t5_bucket(dist) * 16 + 2 * h + mp] * LOG2E; }
        const float c31 = rel_bias[31 * 16 + 2 * h + map] * LOG2E;
        float m_ref = -1e30f, l_part = 0.f;
        f32x16 o[4];
#pragma unroll
        for (int nb = 0; nb < 4; ++nb)
#pragma unroll
            for (int r = 0; r < 16; ++r) o[nb][r] = 0.f;
        const int crow0 = tid >> 4, cch = tid & 15;
        const bf16* kg = Kp + (rowb + crow0) * DM + h * 128 + cch * 8;
        const bf16* vg = Vp + (rowb + crow0) * DM + h * 128 + cch * 8;
        bf16x8 kr[2], vr[2];
#define LOAD_TILE(t) do { _Pragma("unroll") for (int j = 0; j < 2; ++j) { kr[j] = *(const bf16x8*)(kg + ((size_t)(64 * (t)) + 32 * j) * DM); vr[j] = *(const bf16x8*)(vg + ((size_t)(64 * (t)) + 32 * j) * DM); } } while (0)
#define STORE_TILE(bs) do { _Pragma("unroll") for (int j = 0; j < 2; ++j) { *(LAS bf16x8*)(lds + A_K + (bs) * 64 * KSTR + (crow0 + 32 * j) * KSTR + cch * 16) = kr[j]; \
            *(LAS bf16x8*)(lds + A_V + (bs) * 64 * VSTR + (crow0 + 32 * j) * VSTR + cch * 16) = vr[j]; } } while (0)
        LOAD_TILE(0); STORE_TILE(0);
        __syncthreads();
        for (int t = 0; t < NT; ++t) {
            const int bs = t & 1;
            if (t + 1 < NT) LOAD_TILE(t + 1);
            const int kv0 = 64 * t;
            if (kv0 <= q0w + 31) {
                const bool nearT = (q0w - (kv0 + 63)) < 113;
                const LAS unsigned char* Kb = lds + A_K + bs * 64 * KSTR;
                const LAS unsigned char* Vb = lds + A_V + bs * 64 * VSTR;
                f32x16 s[2];
                const float ini = nearT ? 0.f : c31;
#pragma unroll
                for (int hf = 0; hf < 2; ++hf) {
#pragma unroll
                    for (int r = 0; r < 16; ++r) s[hf][r] = ini;
#pragma unroll
                    for (int ds = 0; ds < 4; ++ds) { const bf16x8 kf = *(const LAS bf16x8*)(Kb + (32 * hf + n) * KSTR + (64 * map + 16 * ds + 8 * hi) * 2);
                        s[hf] = __builtin_amdgcn_mfma_f32_32x32x16_bf16(kf, qf[ds], s[hf], 0, 0, 0); }
                }
                if (nearT) {
                    const LAS float* tb = tab + map * 384 + ((q0w + n) + 128 - kv0 - 4 * hi - 27 - 32);
#pragma unroll
                    for (int hf = 0; hf < 2; ++hf)
#pragma unroll
                        for (int r = 0; r < 16; ++r) s[hf][r] += tb[32 - 32 * hf + 27 - ((r & 3) + 8 * (r >> 2))];
                }
                float rm = fmaxf(s[0][0], s[1][0]);
#pragma unroll
                for (int r = 1; r < 16; ++r) rm = fmaxf(rm, fmaxf(s[0][r], s[1][r]));
                rm = swap_max(rm);
                if (__any(rm > m_ref + 8.f)) {
                    const float mn = fmaxf(m_ref, rm); const float al = __builtin_amdgcn_exp2f(m_ref - mn); l_part *= al; m_ref = mn;
                    if (hi == 0) scr[n] = al;
                    LDS_WAIT();
#pragma unroll
                    for (int g4 = 0; g4 < 4; ++g4) { const f32x4 a4 = *(const LAS f32x4*)(scr + 8 * g4 + 4 * hi);
#pragma unroll
                        for (int nb = 0; nb < 4; ++nb)
#pragma unroll
                            for (int j = 0; j < 4; ++j) o[nb][4 * g4 + j] *= a4[j]; }
                    LDS_WAIT();
                }
                bf16x8 pa[4];
#pragma unroll
                for (int hf = 0; hf < 2; ++hf) {
#pragma unroll
                    for (int r = 0; r < 16; ++r) { s[hf][r] = __builtin_amdgcn_exp2f(s[hf][r] - m_ref); l_part += s[hf][r]; }
#pragma unroll
                    for (int c = 0; c < 2; ++c) { v4u w; w.x = pk2(s[hf][8 * c + 0], s[hf][8 * c + 1]); w.y = pk2(s[hf][8 * c + 2], s[hf][8 * c + 3]); w.z = pk2(s[hf][8 * c + 4], s[hf][8 * c + 5]); w.w = pk2(s[hf][8 * c + 6], s[hf][8 * c + 7]);
                        pa[2 * hf + c] = __builtin_bit_cast(bf16x8, w); }
                }
#pragma unroll
                for (int kk = 0; kk < 4; ++kk)
#pragma unroll
                    for (int nb = 0; nb < 4; ++nb) { const LAS unsigned char* vp = Vb + vbase + (16 * kk) * VSTR + 64 * nb;
                        const s16x4 lo = vtr(vp), hi4 = vtr(vp + 8 * VSTR);
                        const bf16x8 vf = (bf16x8){lo[0], lo[1], lo[2], lo[3], hi4[0], hi4[1], hi4[2], hi4[3]};
                        o[nb] = __builtin_amdgcn_mfma_f32_32x32x16_bf16(pa[kk], vf, o[nb], 0, 0, 0); }
            }
            if (t + 1 < NT) STORE_TILE(bs ^ 1);
            __syncthreads();
        }
#undef LOAD_TILE
#undef STORE_TILE
        { const float lt = swap_sum(l_part); float linv = __builtin_amdgcn_rcpf(lt); if (map == 1) linv *= lam;
          if (hi == 0) scr[n] = linv;
          LDS_WAIT();
#pragma unroll
          for (int g4 = 0; g4 < 4; ++g4) { const f32x4 a4 = *(const LAS f32x4*)(scr + 8 * g4 + 4 * hi);
#pragma unroll
              for (int nb = 0; nb < 4; ++nb)
#pragma unroll
                  for (int j = 0; j < 4; ++j) o[nb][4 * g4 + j] *= a4[j]; }
          LDS_WAIT(); }
        if (map == 1) {
#pragma unroll
            for (int nb = 0; nb < 4; ++nb)
#pragma unroll
                for (int r = 0; r < 16; ++r) oex[crow(r, hi) * 128 + 32 * nb + n] = o[nb][r];
        }
        __syncthreads();
        if (map == 0) {
            float ss[16];
#pragma unroll
            for (int r = 0; r < 16; ++r) { float a = 0.f;
#pragma unroll
                for (int nb = 0; nb < 4; ++nb) { o[nb][r] -= oex[crow(r, hi) * 128 + 32 * nb + n]; a += o[nb][r] * o[nb][r]; }
                ss[r] = a; }
#pragma unroll
            for (int r = 0; r < 16; ++r) {
#pragma unroll
                for (int of = 1; of < 32; of <<= 1) ss[r] += __shfl_xor(ss[r], of);
                ss[r] = rsqrtf(ss[r] * (1.f / 128.f) + RMS_EPS); }
            unsigned short* op = (unsigned short*)Op + (rowb + q0w) * DM + h * 128 + n;
#pragma unroll
            for (int r = 0; r < 16; ++r)
#pragma unroll
                for (int nb = 0; nb < 4; ++nb) op[(size_t)crow(r, hi) * DM + 32 * nb] = (unsigned short)(pk2(o[nb][r] * ss[r], 0.f) & 0xffffu);
        }
        __syncthreads();
    }
}

__device__ __forceinline__ void sincos_acc(float x, float& s, float& c) {
    const float q = rintf(x * 0.63661977236758134f);
    float r = fmaf(q, -1.5703125f, x); r = fmaf(q, -4.837512969970703125e-4f, r); r = fmaf(q, -7.54978995489188216e-8f, r);
    const int qi = (int)q; const float r2 = r * r;
    const float sp = r + r * r2 * (-1.6666654611e-1f + r2 * (8.3321608736e-3f + r2 * (-1.9515295891e-4f)));
    const float cp = 1.0f - 0.5f * r2 + r2 * r2 * (4.166664568298827e-2f + r2 * (-1.388731625493765e-3f + r2 * 2.443315711809948e-5f));
    const int k = qi & 3;
    s = (k == 0) ? sp : (k == 1) ? cp : (k == 2) ? -sp : -cp;
    c = (k == 0) ? cp : (k == 1) ? -sp : (k == 2) ? -cp : sp;
}
constexpr int XSTR = 72;
__device__ __forceinline__ void s5_phase(LAS unsigned char* lds, const bf16* __restrict__ XN, bf16* __restrict__ YG, const float* __restrict__ lam_re, const float* __restrict__ lam_im,
                                         const float* __restrict__ log_dt, const float* __restrict__ b_re, const float* __restrict__ b_im, const float* __restrict__ c_re, const float* __restrict__ c_im,
                                         const float* __restrict__ dskip, const float* __restrict__ g2, int vcu, int G) {
    int tid_ = threadIdx.x; asm volatile("" : "+v"(tid_));
    const int tid = tid_, lane = tid & 63, wid = __builtin_amdgcn_readfirstlane(tid >> 6), n = lane & 31, hi = lane >> 5;
    LAS unsigned char* xs = lds + wid * (128 * XSTR);
    for (int pr = wid * G + vcu; pr < 512; pr += 8 * G) {
        const int b = pr >> 6, g = pr & 63;
        const float dt = __expf(log_dt[g]);
        float ar[2], ai[2], cr[2], ci[2];
#pragma unroll
        for (int s = 0; s < 2; ++s) { const int p = n + 32 * s; const float lr = lam_re[g * 64 + p], li = lam_im[g * 64 + p];
            const float er = __expf(lr * dt); float sn, cs; sincos_acc(li * dt, sn, cs); ar[s] = er * cs; ai[s] = er * sn;
            const float d2 = 1.f / (lr * lr + li * li), nr = ar[s] - 1.f, ni = ai[s]; cr[s] = (nr * lr + ni * li) * d2; ci[s] = (ni * lr - nr * li) * d2; }
        bf16x8 Bf[4], Cf[8], Df;
        { float gg[8];
#pragma unroll
          for (int j = 0; j < 8; ++j) gg[j] = g2[16 * g + 8 * hi + j];
#pragma unroll
          for (int nb = 0; nb < 4; ++nb) { const int s = nb & 1, p = n + 32 * s; float v[8];
#pragma unroll
              for (int j = 0; j < 8; ++j) { const float br = b_re[(size_t)(g * 64 + p) * 16 + 8 * hi + j], bi = b_im[(size_t)(g * 64 + p) * 16 + 8 * hi + j];
                  v[j] = ((nb >> 1) == 0 ? (cr[s] * br - ci[s] * bi) : (cr[s] * bi + ci[s] * br)) * gg[j]; }
              v4u w; w.x = pk2(v[0], v[1]); w.y = pk2(v[2], v[3]); w.z = pk2(v[4], v[5]); w.w = pk2(v[6], v[7]); Bf[nb] = __builtin_bit_cast(bf16x8, w); }
#pragma unroll
          for (int kk = 0; kk < 8; ++kk) { float v[8];
#pragma unroll
              for (int j = 0; j < 8; ++j) { const int pp = 16 * (kk & 3) + 8 * hi + j; const int hh = n & 15;
                  const float cv = (kk < 4) ? c_re[(size_t)(g * 16 + hh) * 64 + pp] : -c_im[(size_t)(g * 16 + hh) * 64 + pp]; v[j] = (n < 16) ? cv : 0.f; }
              v4u w; w.x = pk2(v[0], v[1]); w.y = pk2(v[2], v[3]); w.z = pk2(v[4], v[5]); w.w = pk2(v[6], v[7]); Cf[kk] = __builtin_bit_cast(bf16x8, w); }
          { float v[8]; const float dd = dskip[16 * g + (n & 15)] * g2[16 * g + (n & 15)];
#pragma unroll
            for (int j = 0; j < 8; ++j) v[j] = (n < 16 && (8 * hi + j) == n) ? dd : 0.f;
            v4u w; w.x = pk2(v[0], v[1]); w.y = pk2(v[2], v[3]); w.z = pk2(v[4], v[5]); w.w = pk2(v[6], v[7]); Df = __builtin_bit_cast(bf16x8, w); } }
        float x0r = 0.f, x0i = 0.f, x1r = 0.f, x1i = 0.f;
        const int tperm = 16 * ((n >> 2) & 1) + (n & 3) + 4 * (n >> 3);
        const bf16* up = XN + ((size_t)b * SEQ + tperm) * DM + 16 * g + 8 * hi;
        bf16x8 uf = *(const bf16x8*)up;
        const int trb = (8 * hi + ((lane & 15) >> 2)) * XSTR + (16 * ((lane >> 4) & 1) + 4 * (lane & 3)) * 2;
        for (int ch = 0; ch < SEQ / 32; ++ch) {
            bf16x8 ufn = uf;
            if (ch + 1 < SEQ / 32) ufn = *(const bf16x8*)(up + (size_t)(ch + 1) * 32 * DM);
            f32x16 acc[4];
#pragma unroll
            for (int nb = 0; nb < 4; ++nb) {
#pragma unroll
                for (int r = 0; r < 16; ++r) acc[nb][r] = 0.f;
                acc[nb] = __builtin_amdgcn_mfma_f32_32x32x16_bf16(uf, Bf[nb], acc[nb], 0, 0, 0); }
#define S5_SCAN() do { _Pragma("unroll") for (int r = 0; r < 16; ++r) { \
                const float n0r = fmaf(ar[0], x0r, fmaf(-ai[0], x0i, acc[0][r])), n0i = fmaf(ar[0], x0i, fmaf(ai[0], x0r, acc[2][r])); \
                const float n1r = fmaf(ar[1], x1r, fmaf(-ai[1], x1i, acc[1][r])), n1i = fmaf(ar[1], x1i, fmaf(ai[1], x1r, acc[3][r])); \
                x0r = n0r; x0i = n0i; x1r = n1r; x1i = n1i; acc[0][r] = n0r; acc[2][r] = n0i; acc[1][r] = n1r; acc[3][r] = n1i; } } while (0)
#define S5_BCAST(idx) do { auto q0 = __builtin_amdgcn_permlane32_swap(__float_as_uint(x0r), __float_as_uint(x0r), false, false); x0r = __uint_as_float(q0[idx]); \
                auto q1 = __builtin_amdgcn_permlane32_swap(__float_as_uint(x0i), __float_as_uint(x0i), false, false); x0i = __uint_as_float(q1[idx]); \
                auto q2 = __builtin_amdgcn_permlane32_swap(__float_as_uint(x1r), __float_as_uint(x1r), false, false); x1r = __uint_as_float(q2[idx]); \
                auto q3 = __builtin_amdgcn_permlane32_swap(__float_as_uint(x1i), __float_as_uint(x1i), false, false); x1i = __uint_as_float(q3[idx]); } while (0)
            if (hi == 0) S5_SCAN();
            S5_BCAST(0);
            if (hi == 1) S5_SCAN();
            S5_BCAST(1);
#pragma unroll
            for (int nb = 0; nb < 4; ++nb)
#pragma unroll
                for (int k4 = 0; k4 < 4; ++k4) { v2u w; w.x = pk2(acc[nb][4 * k4], acc[nb][4 * k4 + 1]); w.y = pk2(acc[nb][4 * k4 + 2], acc[nb][4 * k4 + 3]);
                    *(LAS v2u*)(xs + (32 * nb + n) * XSTR + (8 * k4 + 4 * hi) * 2) = w; }
            LDS_WAIT();
            f32x16 ya;
#pragma unroll
            for (int r = 0; r < 16; ++r) ya[r] = 0.f;
            ya = __builtin_amdgcn_mfma_f32_32x32x16_bf16(uf, Df, ya, 0, 0, 0);
#pragma unroll
            for (int kk = 0; kk < 8; ++kk) { const LAS unsigned char* p = xs + trb + (16 * kk) * XSTR;
                const s16x4 lo = vtr(p), h4 = vtr(p + 4 * XSTR);
                const bf16x8 xf = (bf16x8){lo[0], lo[1], lo[2], lo[3], h4[0], h4[1], h4[2], h4[3]};
                ya = __builtin_amdgcn_mfma_f32_32x32x16_bf16(xf, Cf[kk], ya, 0, 0, 0); }
            LDS_WAIT();
            if (n < 16) {
                unsigned short* yo = (unsigned short*)YG + ((size_t)b * SEQ + ch * 32 + 16 * hi) * DM + 16 * g + n;
#pragma unroll
                for (int r = 0; r < 16; ++r) { const float y = ya[r]; const float z = 1.5957691216057308f * (y + 0.044715f * y * y * y);
                    const float ge = y * __builtin_amdgcn_rcpf(1.0f + __builtin_amdgcn_exp2f(-LOG2E * z));
                    yo[(size_t)r * DM] = (unsigned short)(pk2(ge, 0.f) & 0xffffu); }
            }
            uf = ufn;
        }
#undef S5_SCAN
#undef S5_BCAST
    }
}

__device__ __forceinline__ const Params* getP() { const Params* p = (const Params*)__builtin_amdgcn_kernarg_segment_ptr(); asm volatile("" : "+s"(p)); return p; }
#define WSP(T, off) ((T*)(getP()->ws + (off)))
#define RUN_GEMM(EPI_T, epi, Aptr, Bptr, N_, K_) do { pg8::Gemm g_{(const pg8::bf16_t*)(Aptr), (const pg8::bf16_t*)(Bptr), M, (N_), (K_)}; pg8::StaticOrder S_; S_.init(M, (N_), (int)gridDim.x, (int)blockIdx.x); \
        pg8::gemm_phase<EPI_T, pg8::StaticOrder, true, true>(lds, g_, S_, epi); } while (0)

__global__ void __launch_bounds__(512) mega_fwd(Params Pdummy) {
    extern __shared__ __attribute__((aligned(16))) unsigned char lds_raw[];
    cg::grid_group grid = cg::this_grid();
    LAS unsigned char* lds = (LAS unsigned char*)lds_raw;
#define TIDV int tid_ = threadIdx.x; asm volatile("" : "+v"(tid_)); const int tid = tid_, lane = tid & 63, wid = __builtin_amdgcn_readfirstlane(tid >> 6); const int G = gridDim.x; const int bx = blockIdx.x; const int vcu = (G % 8 == 0) ? (bx % 8) * (G / 8) + bx / 8 : bx; const int gw = vcu * 8 + wid, NGW = G * 8; (void)tid; (void)lane; (void)gw; (void)NGW;

    {
        TIDV
        LAS float* scr = (LAS float*)(lds + wid * 16384);
        { const Params* P = getP(); const float* norm_g = P->in[2]; bf16* W_in = (bf16*)(P->ws + WS_WIN);
          for (int it = gw; it < 8 * 2816; it += NGW) { const int mat = it / 2816, r = it % 2816, li = mat >> 1, wh = mat & 1;
            transpose_item(P->in[3] + (size_t)mat * DM * 2 * DFF, DM, 2 * DFF, W_in + (size_t)mat * 2 * DFF * DM, norm_g + (li * 8 + (wh ? 4 : 0)) * DM, DM, 1.f, DFF, scr, r, lane); } }
        { const Params* P = getP(); bf16* W_out = (bf16*)(P->ws + WS_WOUT);
          for (int it = gw; it < 8 * 1408; it += NGW) { const int mat = it / 1408, r = it % 1408;
            transpose_item(P->in[4] + (size_t)mat * DFF * DM, DFF, DM, W_out + (size_t)mat * DM * DFF, nullptr, 1, 1.f, 0, scr, r, lane); } }
        { const Params* P = getP(); const float* norm_g = P->in[2]; bf16* W_qkv = (bf16*)(P->ws + WS_WQKV);
          for (int it = gw; it < 2 * 1536; it += NGW) { const int mat = it / 1536, r = it % 1536;
            transpose_item(P->in[5] + (size_t)mat * DM * 3 * DM, DM, 3 * DM, W_qkv + (size_t)mat * 3 * DM * DM, norm_g + ((2 * mat) * 8 + 2) * DM, DM, 1.f, 0, scr, r, lane); } }
        { const Params* P = getP(); bf16* W_o = (bf16*)(P->ws + WS_WO);
          for (int it = gw; it < 2 * 512; it += NGW) { const int mat = it / 512, r = it % 512; const float linit = 0.8f - 0.6f * __expf(-0.3f * (float)(2 * mat));
            transpose_item(P->in[6] + (size_t)mat * DM * DM, DM, DM, W_o + (size_t)mat * DM * DM, P->in[8] + mat * 128, 128, 1.f - linit, 0, scr, r, lane); } }
        { const Params* P = getP(); bf16* W_glu = (bf16*)(P->ws + WS_WGLU);
          for (int it = gw; it < 2 * 1024; it += NGW) { const int mat = it / 1024, r = it % 1024;
            transpose_item(P->in[18] + (size_t)mat * DM * 2 * DM, DM, 2 * DM, W_glu + (size_t)mat * 2 * DM * DM, nullptr, 1, 1.f, DM, scr, r, lane); } }
        { const Params* P = getP(); const float* norm_g = P->in[2]; bf16* W_gate = (bf16*)(P->ws + WS_WGATE);
          for (int it = gw; it < 4 * 512; it += NGW) { const int mat = it / 512, r = it % 512;
            transpose_item(P->in[21] + (size_t)mat * DM * DM, DM, DM, W_gate + (size_t)mat * DM * DM, norm_g + (mat * 8 + 6) * DM, DM, 1.f, 0, scr, r, lane); } }
        { const Params* P = getP(); bf16* W_proj = (bf16*)(P->ws + WS_WPROJ);
          for (int it = gw; it < 4 * 128; it += NGW) { const int mat = it / 128, r = it % 128;
            transpose_item(P->in[20] + (size_t)mat * PLE * DM, PLE, DM, W_proj + (size_t)mat * DM * PLE, nullptr, 1, 1.f, 0, scr, r, lane); } }
        { const Params* P = getP(); const float* p_in = P->in[1]; bf16* PB = (bf16*)(P->ws + WS_PB);
          const size_t n8 = (size_t)4 * M * PLE / 8, nth = (size_t)G * 512;
          for (size_t i = (size_t)vcu * 512 + tid; i < n8; i += nth) { const f32x4 a = ((const f32x4*)p_in)[2 * i], c = ((const f32x4*)p_in)[2 * i + 1];
              v4u w; w.x = pk2(a.x, a.y); w.y = pk2(a.z, a.w); w.z = pk2(c.x, c.y); w.w = pk2(c.z, c.w); ((v4u*)PB)[i] = w; } }
        { const Params* P = getP(); rowpass(P->in[0], nullptr, nullptr, 0.f, P->out, (bf16*)(P->ws + WS_XN), gw, NGW, lane); }
    }
    grid.sync();

    for (int li = 0; li < 4; ++li) {
        for (int sub = 0; sub < 4; ++sub) {
            const int mj = li >> 1; const bool is_ssm = (li & 1) != 0;
            const bool ffn = (sub == 0 || sub == 2);
            if (ffn) {
                const int mat = li * 2 + (sub >> 1);
                pg8::EpiSwiGLU E{WSP(pg8::bf16_t, WS_HQ), DFF};
                RUN_GEMM(pg8::EpiSwiGLU, E, WSP(bf16, WS_XN), WSP(bf16, WS_WIN) + (size_t)mat * 2 * DFF * DM, 2 * DFF, DM);
                grid.sync();
            } else if (sub == 1) {
                if (!is_ssm) {
                    { pg8::EpiBf16S E{WSP(pg8::bf16_t, WS_HQ), DM, DM, (size_t)M * DM, 0.125f * LOG2E};
                      RUN_GEMM(pg8::EpiBf16S, E, WSP(bf16, WS_XN), WSP(bf16, WS_WQKV) + (size_t)mj * 3 * DM * DM, 3 * DM, DM); }
                    grid.sync();
                    { TIDV const Params* P = getP(); bf16* HQ = (bf16*)(P->ws + WS_HQ);
                      const float linit = 0.8f - 0.6f * __expf(-0.3f * (float)li);
                      attention_phase(lds, HQ, HQ + (size_t)M * DM, HQ + (size_t)2 * M * DM, (bf16*)(P->ws + WS_XN), P->in[7] + mj * 256, P->in[9], linit, vcu, G); }
                    grid.sync();
                } else {
                    { TIDV const Params* P = getP();
                      s5_phase(lds, (const bf16*)(P->ws + WS_XN), (bf16*)(P->ws + WS_HQ), P->in[10] + mj * 4096, P->in[11] + mj * 4096, P->in[12] + mj * 64, P->in[13] + (size_t)mj * 65536, P->in[14] + (size_t)mj * 65536,
                             P->in[15] + (size_t)mj * 65536, P->in[16] + (size_t)mj * 65536, P->in[17] + mj * DM, P->in[2] + (li * 8 + 2) * DM, vcu, G); }
                    grid.sync();
                    { const Params* P = getP(); pg8::EpiGLU E{(float*)(P->ws + WS_Y), DM, P->in[19] + mj * 2 * DM, DM};
                      RUN_GEMM(pg8::EpiGLU, E, P->ws + WS_HQ, (bf16*)(P->ws + WS_WGLU) + (size_t)mj * 2 * DM * DM, 2 * DM, DM); }
                }
            }
            if (!(sub == 1 && is_ssm)) {
                const Params* P = getP();
                const bf16* A_; const bf16* B_; int K_;
                if (ffn) { A_ = (const bf16*)(P->ws + WS_HQ); B_ = (const bf16*)(P->ws + WS_WOUT) + (size_t)(li * 2 + (sub >> 1)) * DM * DFF; K_ = DFF; }
                else if (sub == 1) { A_ = (const bf16*)(P->ws + WS_XN); B_ = (const bf16*)(P->ws + WS_WO) + (size_t)mj * DM * DM; K_ = DM; }
                else { A_ = (const bf16*)(P->ws + WS_PB) + (size_t)li * M * PLE; B_ = (const bf16*)(P->ws + WS_WPROJ) + (size_t)li * DM * PLE; K_ = PLE; }
                pg8::EpiF32<0> E{(float*)(P->ws + WS_Y), DM};
                RUN_GEMM(pg8::EpiF32<0>, E, A_, B_, DM, K_);
            }
            if (sub == 3) {
                grid.sync();
                pg8::EpiF32<1> E{WSP(float, WS_Y), DM};
                RUN_GEMM(pg8::EpiF32<1>, E, WSP(bf16, WS_XN), WSP(bf16, WS_WGATE) + (size_t)li * DM * DM, DM, DM);
            }
            grid.sync();
            { TIDV const Params* P = getP();
              rowpass(P->out, (const float*)(P->ws + WS_Y), P->in[2] + (li * 8 + 2 * sub + 1) * DM, ffn ? 0.5f : 1.0f, P->out, (bf16*)(P->ws + WS_XN), gw, NGW, lane); }
            grid.sync();
        }
    }
}

extern "C" void kernel_launch(void* const* d_in, const int* in_sizes, int n_in, void* d_out, int out_size, void* d_ws, size_t ws_size, hipStream_t stream) {
    static int grid = 0;
    if (grid == 0) {
        if (n_in != 22 || out_size != M * DM || ws_size < WS_END) { fprintf(stderr, "kernel_launch: unexpected problem: n_in %d out %d ws %zu\n", n_in, out_size, ws_size); grid = -1; return; }
        int dev = 0, cus = 0, per_cu = 0;
        hipGetDevice(&dev); hipDeviceGetAttribute(&cus, hipDeviceAttributeMultiprocessorCount, dev);
        hipFuncSetAttribute((const void*)mega_fwd, hipFuncAttributeMaxDynamicSharedMemorySize, LDS_BYTES);
        hipOccupancyMaxActiveBlocksPerMultiprocessor(&per_cu, (const void*)mega_fwd, 512, LDS_BYTES);
        (void)hipGetLastError();
        if (per_cu < 1) per_cu = 1;
        grid = cus;
        fprintf(stderr, "kernel_launch: cus %d per_cu %d grid %d\n", cus, per_cu, grid);
    }
    if (grid < 0) return;
    Params p{};
    for (int i = 0; i < 22; ++i) p.in[i] = (const float*)d_in[i];
    p.out = (float*)d_out; p.ws = (unsigned char*)d_ws;
    void* args[] = {&p};
    hipError_t e = hipLaunchCooperativeKernel((const void*)mega_fwd, dim3(grid), dim3(512), args, LDS_BYTES, stream);
    if (e != hipSuccess) fprintf(stderr, "cooperative launch failed: %s (grid %d)\n", hipGetErrorString(e), grid);
}
```
